# Optimizing an MI355X kernel written in HIP

```python
import math
import jax, jax.numpy as jnp
from jax import lax
import numpy as np

D_MODEL = 1024
BATCH = 16
SEQ = 2048
DEPTH = 1

N_DIFF_HEADS = 4
DIFF_HEAD_DIM = 64
DIFF_VDIM = 2 * DIFF_HEAD_DIM
DIFF_WIDTH = N_DIFF_HEADS * DIFF_VDIM
SGU_WIDTH = D_MODEL - DIFF_WIDTH
SGU_GROUPS = 4
SGU_GROUP_DIM = SGU_WIDTH // SGU_GROUPS
CHUNK = 128
Q_BLOCK = 128
ROT_DIM = DIFF_HEAD_DIM // 4
ROPE_THETA = 500000.0
D_FF = ((-(-8 * D_MODEL // 3)) + 255) // 256 * 256
ALPHA = (2 * DEPTH) ** 0.25
BETA = (8 * DEPTH) ** -0.25
LN_EPS = 1e-5
QKV_COLS = DIFF_WIDTH
PROJ_COLS = 3 * QKV_COLS + 2 * SGU_WIDTH

kernel_name = "hybrid_diffattn_sgu_deepnorm_adaln"


def _layernorm(x, g, b):
    xf = x.astype(jnp.float32)
    mu = jnp.mean(xf, axis=-1, keepdims=True)
    var = jnp.mean(jnp.square(xf - mu), axis=-1, keepdims=True)
    y = (xf - mu) * lax.rsqrt(var + LN_EPS)
    return (y * g.astype(jnp.float32) + b.astype(jnp.float32)).astype(x.dtype)


def _rmsnorm(x, g):
    xf = x.astype(jnp.float32)
    y = xf * lax.rsqrt(jnp.mean(jnp.square(xf), axis=-1, keepdims=True) + LN_EPS)
    return (y * g.astype(jnp.float32)).astype(x.dtype)


def _rope_tables(seq):
    half = ROT_DIM // 2
    inv_freq = ROPE_THETA ** (-jnp.arange(half, dtype=jnp.float32) * 2.0 / ROT_DIM)
    ang = jnp.arange(seq, dtype=jnp.float32)[:, None] * inv_freq[None, :]
    return jnp.cos(ang), jnp.sin(ang)


def _partial_rope(t, cos, sin):
    half = ROT_DIM // 2
    cs = cos[None, :, None, :].astype(t.dtype)
    sn = sin[None, :, None, :].astype(t.dtype)
    t1, t2, tp = t[..., :half], t[..., half:ROT_DIM], t[..., ROT_DIM:]
    return jnp.concatenate([t1 * cs - t2 * sn, t1 * sn + t2 * cs, tp], axis=-1)


def _diff_attention(q, k, v, lam, lam_init, subln_g, cos, sin):
    B, S, _ = q.shape
    H, d = N_DIFF_HEADS, DIFF_HEAD_DIM
    q = _partial_rope(q.reshape(B, S, 2 * H, d), cos, sin)
    k = _partial_rope(k.reshape(B, S, 2 * H, d), cos, sin)
    q = (q * (d ** -0.5)).reshape(B, S, H, 2, d).transpose(0, 2, 3, 1, 4)
    k = k.reshape(B, S, H, 2, d).transpose(0, 2, 3, 1, 4)
    v = v.reshape(B, S, H, DIFF_VDIM).transpose(0, 2, 1, 3)
    n_blocks = S // Q_BLOCK
    kpos = jnp.arange(S)

    def block(i):
        qi = lax.dynamic_slice_in_dim(q, i * Q_BLOCK, Q_BLOCK, axis=3)
        s = jnp.einsum('bhcqd,bhckd->bhcqk', qi, k).astype(jnp.float32)
        qpos = i * Q_BLOCK + jnp.arange(Q_BLOCK)
        mask = kpos[None, :] <= qpos[:, None]
        s = jnp.where(mask, s, jnp.finfo(jnp.float32).min)
        p = jax.nn.softmax(s, axis=-1)
        a = (p[:, :, 0] - lam * p[:, :, 1]).astype(v.dtype)
        return jnp.einsum('bhqk,bhke->bhqe', a, v)

    o = lax.map(block, jnp.arange(n_blocks))
    o = o.transpose(1, 0, 3, 2, 4).reshape(B, S, H, DIFF_VDIM)
    o = _rmsnorm(o, subln_g) * (1.0 - lam_init)
    return o.reshape(B, S, DIFF_WIDTH)


def _spatial_gating(z, ln_g, ln_b, w_s, b_s):
    B, S, _ = z.shape
    u, v = z[..., :SGU_WIDTH], z[..., SGU_WIDTH:]
    v = _layernorm(v, ln_g, ln_b)
    v = v.reshape(B, S // CHUNK, CHUNK, SGU_GROUPS, SGU_GROUP_DIM)
    causal = jnp.tril(jnp.ones((CHUNK, CHUNK), dtype=bool))
    w = jnp.where(causal[None], w_s, jnp.zeros_like(w_s))
    sv = jnp.einsum('gts,bnsgc->bntgc', w, v) + b_s.T[None, None, :, :, None]
    return u * sv.reshape(B, S, SGU_WIDTH)


def _swiglu(h, w_gate, w_up, w_down):
    return (jax.nn.silu(h @ w_gate) * (h @ w_up)) @ w_down


def setup_inputs(seed: int = 0) -> dict:
    key = jax.random.key(seed)
    ks = jax.random.split(key, 24)
    D = D_MODEL
    f32 = jnp.float32
    nrm = lambda k, shape, s: (jax.random.normal(k, shape, f32) * s)
    x = nrm(ks[0], (BATCH, SEQ, D), 1.0)
    c = nrm(ks[1], (BATCH, D), 1.0)
    ada_w = nrm(ks[2], (DEPTH, D, 6 * D), D ** -0.5)
    ada_b = nrm(ks[3], (DEPTH, 6 * D), 0.02)
    w_qk = nrm(ks[4], (DEPTH, D, 2 * QKV_COLS), D ** -0.5)
    w_vs = nrm(ks[5], (DEPTH, D, QKV_COLS + 2 * SGU_WIDTH), D ** -0.5 * BETA)
    w_in = jnp.concatenate([w_qk, w_vs], axis=-1)
    lambda_q1 = nrm(ks[6], (DEPTH, DIFF_HEAD_DIM), 0.1)
    lambda_k1 = nrm(ks[7], (DEPTH, DIFF_HEAD_DIM), 0.1)
    lambda_q2 = nrm(ks[8], (DEPTH, DIFF_HEAD_DIM), 0.1)
    lambda_k2 = nrm(ks[9], (DEPTH, DIFF_HEAD_DIM), 0.1)
    subln_g = 1.0 + nrm(ks[10], (DEPTH, DIFF_VDIM), 0.02)
    sgu_ln_g = 1.0 + nrm(ks[11], (DEPTH, SGU_WIDTH), 0.02)
    sgu_ln_b = nrm(ks[12], (DEPTH, SGU_WIDTH), 0.02)
    sgu_w = nrm(ks[13], (DEPTH, SGU_GROUPS, CHUNK, CHUNK), CHUNK ** -0.5)
    sgu_b = 1.0 + nrm(ks[14], (DEPTH, SGU_GROUPS, CHUNK), 0.1)
    w_o = nrm(ks[15], (DEPTH, D, D), D ** -0.5 * BETA)
    ln1_g = 1.0 + nrm(ks[16], (DEPTH, D), 0.02)
    ln1_b = nrm(ks[17], (DEPTH, D), 0.02)
    w_gate = nrm(ks[18], (DEPTH, D, D_FF), D ** -0.5 * BETA)
    w_up = nrm(ks[19], (DEPTH, D, D_FF), D ** -0.5 * BETA)
    w_down = nrm(ks[20], (DEPTH, D_FF, D), D_FF ** -0.5 * BETA)
    ln2_g = 1.0 + nrm(ks[21], (DEPTH, D), 0.02)
    ln2_b = nrm(ks[22], (DEPTH, D), 0.02)
    return {"x": x, "c": c, "ada_w": ada_w, "ada_b": ada_b, "w_in": w_in,
            "lambda_q1": lambda_q1, "lambda_k1": lambda_k1, "lambda_q2": lambda_q2,
            "lambda_k2": lambda_k2, "subln_g": subln_g, "sgu_ln_g": sgu_ln_g,
            "sgu_ln_b": sgu_ln_b, "sgu_w": sgu_w, "sgu_b": sgu_b, "w_o": w_o,
            "ln1_g": ln1_g, "ln1_b": ln1_b, "w_gate": w_gate, "w_up": w_up,
            "w_down": w_down, "ln2_g": ln2_g, "ln2_b": ln2_b}


def reference(x, c, ada_w, ada_b, w_in, lambda_q1, lambda_k1, lambda_q2, lambda_k2,
              subln_g, sgu_ln_g, sgu_ln_b, sgu_w, sgu_b, w_o, ln1_g, ln1_b,
              w_gate, w_up, w_down, ln2_g, ln2_b):
    B, S, D = x.shape
    cos, sin = _rope_tables(S)
    c_act = jax.nn.silu(c)
    o1, o2, o3 = QKV_COLS, 2 * QKV_COLS, 3 * QKV_COLS
    for l in range(DEPTH):
        lam_init = 0.8 - 0.6 * math.exp(-0.3 * l)
        mod = c_act @ ada_w[l] + ada_b[l]
        shift1, scale1, gate1, shift2, scale2, gate2 = [m[:, None, :] for m in jnp.split(mod, 6, axis=-1)]

        h = x * (1.0 + scale1) + shift1
        proj = h @ w_in[l]
        lam = (jnp.exp(jnp.sum(lambda_q1[l] * lambda_k1[l]).astype(jnp.float32))
               - jnp.exp(jnp.sum(lambda_q2[l] * lambda_k2[l]).astype(jnp.float32)) + lam_init)
        attn_out = _diff_attention(proj[..., :o1], proj[..., o1:o2], proj[..., o2:o3],
                                   lam, lam_init, subln_g[l], cos, sin)
        sgu_out = _spatial_gating(jax.nn.gelu(proj[..., o3:], approximate=False),
                                  sgu_ln_g[l], sgu_ln_b[l], sgu_w[l], sgu_b[l])
        mix = jnp.concatenate([attn_out, sgu_out], axis=-1) @ w_o[l]
        x = _layernorm(ALPHA * x + gate1 * mix, ln1_g[l], ln1_b[l])

        h2 = x * (1.0 + scale2) + shift2
        ffn = _swiglu(h2, w_gate[l], w_up[l], w_down[l])
        x = _layernorm(ALPHA * x + gate2 * ffn, ln2_g[l], ln2_b[l])
    return x
```

```cpp
#include <hip/hip_runtime.h>
#include <cstdio>
#include <cstdint>

namespace {
constexpr int B_ = 16, S_ = 2048, D_ = 1024, M_ = B_ * S_;
constexpr int NPROJ = 2560, FF = 2816, MODW = 6 * D_;
constexpr float ALPHA = 1.189207115002721f;
constexpr float LN_EPS = 1e-5f;
constexpr float LAM_INIT = 0.2f;

__global__ void __launch_bounds__(256) k_mod(const float* __restrict__ c, const float* __restrict__ w, const float* __restrict__ bias, float* __restrict__ mod) {
    const int j = blockIdx.x * 256 + threadIdx.x, b = blockIdx.y;
    float acc = 0.f;
    for (int k = 0; k < D_; ++k) { const float v = c[b * D_ + k]; const float s = v / (1.f + expf(-v)); acc += s * w[(size_t)k * MODW + j]; }
    mod[b * MODW + j] = acc + bias[j];
}
__global__ void k_rope_table(float* __restrict__ tab) {
    const int idx = blockIdx.x * 256 + threadIdx.x; if (idx >= S_ * 8) return;
    const int pos = idx >> 3, i = idx & 7;
    const double invf = exp(-(double)i / 8.0 * log(500000.0)); const double ang = (double)pos * invf;
    tab[idx * 2] = (float)cos(ang); tab[idx * 2 + 1] = (float)sin(ang);
}
template <bool MODA, int EPI>
__global__ void __launch_bounds__(256) k_gemm(const float* __restrict__ A, const float* __restrict__ Bm, float* C, int N, int K, const float* __restrict__ mod, int sc_off, int sh_off) {
    __shared__ float As[16][132];
    __shared__ float Bs[16][128];
    const int tid = threadIdx.x, tx = tid & 15, ty = tid >> 4;
    const int bm = blockIdx.y * 128, bn = blockIdx.x * 128;
    float acc[8][8];
#pragma unroll
    for (int i = 0; i < 8; ++i)
#pragma unroll
        for (int j = 0; j < 8; ++j) acc[i][j] = 0.f;
    const int ar = tid >> 2, akc = (tid & 3) * 4;
    const int br = tid >> 5, bc = (tid & 31) * 4;
    for (int k0 = 0; k0 < K; k0 += 16) {
#pragma unroll
        for (int i = 0; i < 2; ++i) {
            const int r = ar + 64 * i;
            float4 v = *(const float4*)(A + (size_t)(bm + r) * K + k0 + akc);
            if (MODA) { const float* mb = mod + (size_t)((bm + r) / S_) * MODW; const float4 sc = *(const float4*)(mb + sc_off + k0 + akc), sh = *(const float4*)(mb + sh_off + k0 + akc);
                v.x = v.x * (1.f + sc.x) + sh.x; v.y = v.y * (1.f + sc.y) + sh.y; v.z = v.z * (1.f + sc.z) + sh.z; v.w = v.w * (1.f + sc.w) + sh.w; }
            As[akc + 0][r] = v.x; As[akc + 1][r] = v.y; As[akc + 2][r] = v.z; As[akc + 3][r] = v.w;
        }
#pragma unroll
        for (int i = 0; i < 2; ++i) { const int r = br + 8 * i; *(float4*)&Bs[r][bc] = *(const float4*)(Bm + (size_t)(k0 + r) * N + bn + bc); }
        __syncthreads();
#pragma unroll
        for (int k = 0; k < 16; ++k) {
            const float4 a0 = *(const float4*)&As[k][ty * 4], a1 = *(const float4*)&As[k][64 + ty * 4];
            const float4 b0 = *(const float4*)&Bs[k][tx * 4], b1 = *(const float4*)&Bs[k][64 + tx * 4];
            const float a[8] = {a0.x, a0.y, a0.z, a0.w, a1.x, a1.y, a1.z, a1.w};
            const float b[8] = {b0.x, b0.y, b0.z, b0.w, b1.x, b1.y, b1.z, b1.w};
#pragma unroll
            for (int i = 0; i < 8; ++i)
#pragma unroll
                for (int j = 0; j < 8; ++j) acc[i][j] += a[i] * b[j];
        }
        __syncthreads();
    }
#pragma unroll
    for (int i = 0; i < 8; ++i) {
        const int row = bm + (i < 4 ? ty * 4 + i : 64 + ty * 4 + (i - 4));
#pragma unroll
        for (int jh = 0; jh < 2; ++jh) {
            const int col = bn + jh * 64 + tx * 4; float* p = C + (size_t)row * N + col;
            float4 o = {acc[i][jh * 4 + 0], acc[i][jh * 4 + 1], acc[i][jh * 4 + 2], acc[i][jh * 4 + 3]};
            if (EPI == 1) { const float4 u = *(const float4*)p;
                o.x = o.x / (1.f + expf(-o.x)) * u.x; o.y = o.y / (1.f + expf(-o.y)) * u.y; o.z = o.z / (1.f + expf(-o.z)) * u.z; o.w = o.w / (1.f + expf(-o.w)) * u.w; }
            *(float4*)p = o;
        }
    }
}
__global__ void __launch_bounds__(256) k_rope(float* __restrict__ proj, const float* __restrict__ tab) {
    const size_t idx = (size_t)blockIdx.x * 256 + threadIdx.x;
    const int i = idx & 7, n = (idx >> 3) & 15; const size_t m = idx >> 7; if (m >= (size_t)M_) return;
    const int pos = (int)(m % S_);
    const float cs = tab[(pos * 8 + i) * 2], sn = tab[(pos * 8 + i) * 2 + 1];
    float* p = proj + m * NPROJ + n * 64;
    const float t1 = p[i], t2 = p[8 + i];
    p[i] = t1 * cs - t2 * sn; p[8 + i] = t1 * sn + t2 * cs;
}
__global__ void __launch_bounds__(256) k_attn(const float* __restrict__ proj, const float* __restrict__ lq1, const float* __restrict__ lk1, const float* __restrict__ lq2, const float* __restrict__ lk2,
                                              const float* __restrict__ subg, float* __restrict__ mixin) {
    __shared__ float qs[2][32][65];
    __shared__ float ks[2][32][65];
    __shared__ float vs[32][128];
    __shared__ float ss[2][32][33];
    __shared__ float mrow[64], lrow[64], srow[64];
    const int tid = threadIdx.x;
    const int qt = blockIdx.x, h = blockIdx.y, b = blockIdx.z;
    const size_t row0 = (size_t)b * S_;
    float lam;
    { float s1 = 0.f, s2 = 0.f; for (int i = 0; i < 64; ++i) { s1 += lq1[i] * lk1[i]; s2 += lq2[i] * lk2[i]; } lam = expf(s1) - expf(s2) + LAM_INIT; }
    for (int e = tid; e < 2 * 32 * 64; e += 256) { const int c = e >> 11, r = (e >> 6) & 31, d = e & 63;
        qs[c][r][d] = proj[(row0 + qt * 32 + r) * NPROJ + (2 * h + c) * 64 + d] * 0.125f; }
    if (tid < 64) { mrow[tid] = -1e30f; lrow[tid] = 0.f; }
    float acc[32];
#pragma unroll
    for (int j = 0; j < 32; ++j) acc[j] = 0.f;
    const int oc = tid >> 7, orow = (tid & 127) >> 2, og = tid & 3;
    __syncthreads();
    for (int kt = 0; kt <= qt; ++kt) {
        for (int e = tid; e < 2 * 32 * 64; e += 256) { const int c = e >> 11, r = (e >> 6) & 31, d = e & 63;
            ks[c][r][d] = proj[(row0 + kt * 32 + r) * NPROJ + 512 + (2 * h + c) * 64 + d]; }
        for (int e = tid; e < 32 * 128; e += 256) { const int r = e >> 7, d = e & 127; vs[r][d] = proj[(row0 + kt * 32 + r) * NPROJ + 1024 + h * 128 + d]; }
        __syncthreads();
        for (int e = tid; e < 2048; e += 256) { const int c = e >> 10, r = (e >> 5) & 31, kk = e & 31;
            float s = 0.f;
#pragma unroll 16
            for (int d = 0; d < 64; ++d) s += qs[c][r][d] * ks[c][kk][d];
            if (kt * 32 + kk > qt * 32 + r) s = -1e30f;
            ss[c][r][kk] = s; }
        __syncthreads();
        if (tid < 64) { const int c = tid >> 5, r = tid & 31; float mx = -1e30f;
            for (int kk = 0; kk < 32; ++kk) mx = fmaxf(mx, ss[c][r][kk]);
            const float mo = mrow[tid], mn = fmaxf(mo, mx), sc = expf(mo - mn); float sum = 0.f;
            for (int kk = 0; kk < 32; ++kk) { const float s = ss[c][r][kk]; const float p = (s <= -1e29f) ? 0.f : expf(s - mn); ss[c][r][kk] = p; sum += p; }
            mrow[tid] = mn; lrow[tid] = lrow[tid] * sc + sum; srow[tid] = sc; }
        __syncthreads();
        { const float sc = srow[oc * 32 + orow];
#pragma unroll
          for (int j = 0; j < 32; ++j) acc[j] *= sc;
          for (int kk = 0; kk < 32; ++kk) { const float p = ss[oc][orow][kk];
#pragma unroll
              for (int j = 0; j < 32; ++j) acc[j] += p * vs[kk][j * 4 + og]; } }
        __syncthreads();
    }
    float* obuf = &ks[0][0][0];
    { const float il = 1.f / lrow[oc * 32 + orow];
#pragma unroll
      for (int j = 0; j < 32; ++j) acc[j] *= il; }
    if (oc == 1) {
#pragma unroll
        for (int j = 0; j < 32; ++j) obuf[orow * 128 + j * 4 + og] = acc[j]; }
    __syncthreads();
    if (oc == 0) {
        float ssq = 0.f;
#pragma unroll
        for (int j = 0; j < 32; ++j) { acc[j] = acc[j] - lam * obuf[orow * 128 + j * 4 + og]; ssq += acc[j] * acc[j]; }
        ssq += __shfl_xor(ssq, 1); ssq += __shfl_xor(ssq, 2);
        const float rs = 1.f / sqrtf(ssq * (1.f / 128.f) + LN_EPS) * (1.f - LAM_INIT);
#pragma unroll
        for (int j = 0; j < 32; ++j) { const int d = j * 4 + og; mixin[(row0 + qt * 32 + orow) * D_ + h * 128 + d] = acc[j] * rs * subg[d]; }
    }
}
__device__ __forceinline__ float gelu_exact(float v) { return 0.5f * v * (1.f + erff(v * 0.70710678118654752f)); }
__global__ void __launch_bounds__(256) k_sgu_stats(const float* __restrict__ proj, float* __restrict__ stats) {
    const int wave = threadIdx.x >> 6, lane = threadIdx.x & 63; const size_t m = (size_t)blockIdx.x * 4 + wave;
    const float* p = proj + m * NPROJ + 2048;
    float v[8]; float s = 0.f;
#pragma unroll
    for (int j = 0; j < 8; ++j) { v[j] = gelu_exact(p[lane + 64 * j]); s += v[j]; }
#pragma unroll
    for (int o = 1; o < 64; o <<= 1) s += __shfl_xor(s, o);
    const float mean = s * (1.f / 512.f); float q = 0.f;
#pragma unroll
    for (int j = 0; j < 8; ++j) { const float d = v[j] - mean; q += d * d; }
#pragma unroll
    for (int o = 1; o < 64; o <<= 1) q += __shfl_xor(q, o);
    if (lane == 0) { stats[m * 2] = mean; stats[m * 2 + 1] = 1.f / sqrtf(q * (1.f / 512.f) + LN_EPS); }
}
__global__ void __launch_bounds__(256) k_sgu(const float* __restrict__ proj, const float* __restrict__ stats, const float* __restrict__ lng, const float* __restrict__ lnb,
                                             const float* __restrict__ w, const float* __restrict__ bs, float* __restrict__ mixin) {
    __shared__ float vn[128][64];
    const int tid = threadIdx.x; const int n = blockIdx.x, g = blockIdx.y >> 1, chh = blockIdx.y & 1, b = blockIdx.z;
    const size_t row0 = (size_t)b * S_ + n * 128; const int ch0 = g * 128 + chh * 64;
    for (int e = tid; e < 128 * 64; e += 256) { const int s = e >> 6, c = e & 63; const size_t m = row0 + s;
        const float v = gelu_exact(proj[m * NPROJ + 2048 + ch0 + c]);
        vn[s][c] = (v - stats[m * 2]) * stats[m * 2 + 1] * lng[ch0 + c] + lnb[ch0 + c]; }
    __syncthreads();
    const int c = tid & 63, tq = tid >> 6;
    for (int t = tq; t < 128; t += 4) {
        const float* wr = w + ((size_t)g * 128 + t) * 128; float acc = 0.f;
        for (int s = 0; s <= t; ++s) acc += wr[s] * vn[s][c];
        const size_t m = row0 + t;
        const float u = gelu_exact(proj[m * NPROJ + 1536 + ch0 + c]);
        mixin[m * D_ + 512 + ch0 + c] = u * (acc + bs[g * 128 + t]);
    }
}
__global__ void __launch_bounds__(256) k_ln_res(const float* xin, const float* __restrict__ y, const float* __restrict__ mod, int gate_off, const float* __restrict__ g, const float* __restrict__ bta, float* out) {
    const int wave = threadIdx.x >> 6, lane = threadIdx.x & 63; const size_t m = (size_t)blockIdx.x * 4 + wave;
    const float* mb = mod + (m / S_) * MODW + gate_off;
    float v[16]; float s = 0.f;
#pragma unroll
    for (int j = 0; j < 4; ++j) { const int col = j * 256 + lane * 4; const float4 xv = *(const float4*)(xin + m * D_ + col), yv = *(const float4*)(y + m * D_ + col), gv = *(const float4*)(mb + col);
        v[j * 4 + 0] = ALPHA * xv.x + gv.x * yv.x; v[j * 4 + 1] = ALPHA * xv.y + gv.y * yv.y; v[j * 4 + 2] = ALPHA * xv.z + gv.z * yv.z; v[j * 4 + 3] = ALPHA * xv.w + gv.w * yv.w;
        s += (v[j * 4] + v[j * 4 + 1]) + (v[j * 4 + 2] + v[j * 4 + 3]); }
#pragma unroll
    for (int o = 1; o < 64; o <<= 1) s += __shfl_xor(s, o);
    const float mean = s * (1.f / D_); float q = 0.f;
#pragma unroll
    for (int j = 0; j < 16; ++j) { v[j] -= mean; q += v[j] * v[j]; }
#pragma unroll
    for (int o = 1; o < 64; o <<= 1) q += __shfl_xor(q, o);
    const float rstd = 1.f / sqrtf(q * (1.f / D_) + LN_EPS);
#pragma unroll
    for (int j = 0; j < 4; ++j) { const int col = j * 256 + lane * 4; const float4 gv = *(const float4*)(g + col), bv = *(const float4*)(bta + col);
        float4 o = {v[j * 4] * rstd * gv.x + bv.x, v[j * 4 + 1] * rstd * gv.y + bv.y, v[j * 4 + 2] * rstd * gv.z + bv.z, v[j * 4 + 3] * rstd * gv.w + bv.w};
        *(float4*)(out + m * D_ + col) = o; }
}
}

extern "C" void kernel_launch(void* const* d_in, const int* in_sizes, int n_in, void* d_out, int out_size, void* d_ws, size_t ws_size, hipStream_t stream) {
    const float* x = (const float*)d_in[0]; const float* c = (const float*)d_in[1]; const float* ada_w = (const float*)d_in[2]; const float* ada_b = (const float*)d_in[3];
    const float* w_in = (const float*)d_in[4]; const float* lq1 = (const float*)d_in[5]; const float* lk1 = (const float*)d_in[6]; const float* lq2 = (const float*)d_in[7]; const float* lk2 = (const float*)d_in[8];
    const float* subg = (const float*)d_in[9]; const float* sln_g = (const float*)d_in[10]; const float* sln_b = (const float*)d_in[11]; const float* sgu_w = (const float*)d_in[12]; const float* sgu_b = (const float*)d_in[13];
    const float* w_o = (const float*)d_in[14]; const float* ln1_g = (const float*)d_in[15]; const float* ln1_b = (const float*)d_in[16]; const float* w_gate = (const float*)d_in[17]; const float* w_up = (const float*)d_in[18];
    const float* w_down = (const float*)d_in[19]; const float* ln2_g = (const float*)d_in[20]; const float* ln2_b = (const float*)d_in[21];
    float* out = (float*)d_out; char* ws = (char*)d_ws;
    const size_t MiB = 1u << 20;
    float* mod = (float*)(ws);
    float* tab = (float*)(ws + 1 * MiB);
    float* stats = (float*)(ws + 2 * MiB);
    float* proj = (float*)(ws + 4 * MiB);
    float* mixin = (float*)(ws + 324 * MiB);
    float* mix = proj;
    float* U = (float*)(ws + 4 * MiB);
    float* ffn = (float*)(ws + 356 * MiB);
    if (ws_size < 484 * MiB) { fprintf(stderr, "workspace too small\n"); return; }

    k_mod<<<dim3(MODW / 256, B_), 256, 0, stream>>>(c, ada_w, ada_b, mod);
    k_rope_table<<<(S_ * 8 + 255) / 256, 256, 0, stream>>>(tab);
    k_gemm<true, 0><<<dim3(NPROJ / 128, M_ / 128), 256, 0, stream>>>(x, w_in, proj, NPROJ, D_, mod, 1024, 0);
    k_rope<<<(unsigned)(((size_t)M_ * 128 + 255) / 256), 256, 0, stream>>>(proj, tab);
    k_attn<<<dim3(S_ / 32, 4, B_), 256, 0, stream>>>(proj, lq1, lk1, lq2, lk2, subg, mixin);
    k_sgu_stats<<<M_ / 4, 256, 0, stream>>>(proj, stats);
    k_sgu<<<dim3(S_ / 128, 8, B_), 256, 0, stream>>>(proj, stats, sln_g, sln_b, sgu_w, sgu_b, mixin);
    k_gemm<false, 0><<<dim3(D_ / 128, M_ / 128), 256, 0, stream>>>(mixin, w_o, mix, D_, D_, nullptr, 0, 0);
    k_ln_res<<<M_ / 4, 256, 0, stream>>>(x, mix, mod, 2048, ln1_g, ln1_b, out);
    k_gemm<true, 0><<<dim3(FF / 128, M_ / 128), 256, 0, stream>>>(out, w_up, U, FF, D_, mod, 4096, 3072);
    k_gemm<true, 1><<<dim3(FF / 128, M_ / 128), 256, 0, stream>>>(out, w_gate, U, FF, D_, mod, 4096, 3072);
    k_gemm<false, 0><<<dim3(D_ / 128, M_ / 128), 256, 0, stream>>>(U, w_down, ffn, D_, FF, nullptr, 0, 0);
    k_ln_res<<<M_ / 4, 256, 0, stream>>>(out, ffn, mod, 5120, ln2_g, ln2_b, out);
}
```
